# Optimizing an MI355X kernel written in HIP

```python
import math
import jax, jax.numpy as jnp
from jax import lax
import numpy as np

D_MODEL = 1024
BATCH = 1
SEQ = 16384
DEPTH = 1

HEAD_DIM = 64
N_HEADS_A = 8
N_KV_A = 2
N_HEADS_B = 8
D_A = N_HEADS_A * HEAD_DIM
D_KV_A = N_KV_A * HEAD_DIM
D_B = N_HEADS_B * HEAD_DIM
D_MIX = D_A + D_B
D_IN = D_A + 2 * D_KV_A + 3 * D_B
D_FF = 4 * D_MODEL
D_PLE = 256
GRID_W = 64
ROPE_THETA = 10000.0
ROPE_HALF = HEAD_DIM // 2
Q_BLOCK = 128
DILATED_PATTERNS = ((128, 1), (512, 4), (2048, 16))
N_BUCKETS = 32
MAX_DISTANCE = 1024
EPS = 1e-6
NEG_BIG = -1e30

kernel_name = "hymba_axial_gqa_dilated_swa_encoder_layer"


def rms_norm(x, g):
    xf = x.astype(jnp.float32)
    y = xf * lax.rsqrt(jnp.mean(xf * xf, axis=-1, keepdims=True) + EPS)
    return (y * g.astype(jnp.float32)).astype(x.dtype)


def axial_rope_tables(n_tokens):
    rows = n_tokens // GRID_W
    row = jnp.broadcast_to(jnp.arange(rows)[:, None], (rows, GRID_W)).reshape(-1).astype(jnp.float32)
    col = jnp.broadcast_to(jnp.arange(GRID_W)[None, :], (rows, GRID_W)).reshape(-1).astype(jnp.float32)
    n_axis = ROPE_HALF // 2
    inv_freq = ROPE_THETA ** (-jnp.arange(n_axis, dtype=jnp.float32) / n_axis)
    ang = jnp.concatenate([row[:, None] * inv_freq, col[:, None] * inv_freq], axis=-1)
    return jnp.cos(ang), jnp.sin(ang)


def apply_rope(x, cos, sin):
    xf = x.astype(jnp.float32)
    x1, x2 = xf[..., :ROPE_HALF], xf[..., ROPE_HALF:]
    c, s = cos[None, :, None, :], sin[None, :, None, :]
    return jnp.concatenate([x1 * c - x2 * s, x2 * c + x1 * s], axis=-1).astype(x.dtype)


def mixer_a(q, k, v, g_q, g_k, cos, sin):
    q = apply_rope(rms_norm(q, g_q), cos, sin)
    k = apply_rope(rms_norm(k, g_k), cos, sin)
    b, s_len = q.shape[0], q.shape[1]
    grp = N_HEADS_A // N_KV_A
    nblk = s_len // Q_BLOCK
    qb = q.reshape(b, nblk, Q_BLOCK, N_KV_A, grp, HEAD_DIM).transpose(1, 0, 2, 3, 4, 5)
    scale = HEAD_DIM ** -0.5

    def block(q_blk):
        sc = jnp.einsum('bqkgd,bskd->bkgqs', q_blk, k, preferred_element_type=jnp.float32) * scale
        pr = jax.nn.softmax(sc, axis=-1)
        return jnp.einsum('bkgqs,bskd->bqkgd', pr.astype(v.dtype), v)

    o = lax.map(block, qb)
    return o.transpose(1, 0, 2, 3, 4, 5).reshape(b, s_len, D_A)


def t5_bucket(rel):
    nb = N_BUCKETS // 2
    max_exact = nb // 2
    side = jnp.where(rel > 0, nb, 0)
    n = jnp.abs(rel)
    large = max_exact + (jnp.log(jnp.maximum(n, max_exact).astype(jnp.float32) / max_exact)
                         / math.log(MAX_DISTANCE / max_exact) * (nb - max_exact)).astype(jnp.int32)
    large = jnp.minimum(large, nb - 1)
    return side + jnp.where(n < max_exact, n, large)


def dilated_pattern(q, k, v, rel_bias, window, dilation):
    b, s_len, h, d = q.shape
    length = s_len // dilation
    half = window // (2 * dilation)
    blk = half
    nblk = -(-length // blk)
    lp = nblk * blk

    def to_sub(x):
        x = x.reshape(b, length, dilation, h, d).transpose(0, 2, 1, 3, 4)
        return jnp.pad(x, ((0, 0), (0, 0), (0, lp - length), (0, 0), (0, 0)))

    def band(x):
        xp = jnp.pad(to_sub(x), ((0, 0), (0, 0), (blk, blk), (0, 0), (0, 0)))
        xb = xp.reshape(b, dilation, nblk + 2, blk, h, d)
        return jnp.concatenate([xb[:, :, :-2], xb[:, :, 1:-1], xb[:, :, 2:]], axis=3)

    qs = to_sub(q).reshape(b, dilation, nblk, blk, h, d)
    ks, vs = band(k), band(v)
    qi = jnp.arange(blk)
    kj = jnp.arange(3 * blk)
    rel = kj[None, :] - blk - qi[:, None]
    key_m = jnp.arange(nblk)[:, None] * blk - blk + kj[None, :]
    valid = ((jnp.abs(rel) <= half)[None, :, :]
             & (key_m >= 0)[:, None, :] & (key_m < length)[:, None, :])
    bias = rel_bias[t5_bucket(rel * dilation)].astype(jnp.float32)
    bias = bias.transpose(0, 2, 1)[None, None, None]
    sc = jnp.einsum('brnqhd,brnkhd->brnqhk', qs, ks, preferred_element_type=jnp.float32) * (HEAD_DIM ** -0.5)
    sc = jnp.where(valid[None, None, :, :, None, :], sc + bias, NEG_BIG)
    mx = jnp.max(sc, axis=-1)
    e = jnp.exp(sc - mx[..., None])
    den = jnp.sum(e, axis=-1)
    o = jnp.einsum('brnqhk,brnkhd->brnqhd', e.astype(vs.dtype), vs,
                   preferred_element_type=jnp.float32) / den[..., None]

    def from_sub(y):
        y = y.reshape((b, dilation, lp) + y.shape[4:])[:, :, :length]
        return jnp.moveaxis(y, 1, 2).reshape((b, s_len) + y.shape[3:])

    return from_sub(o), from_sub(mx), from_sub(den)


def mixer_b(q, k, v, rel_bias):
    outs, mxs, dens = [], [], []
    for window, dilation in DILATED_PATTERNS:
        o, mx, den = dilated_pattern(q, k, v, rel_bias, window, dilation)
        outs.append(o); mxs.append(mx); dens.append(den)
    m_all = jnp.maximum(jnp.maximum(mxs[0], mxs[1]), mxs[2])
    w = [den * jnp.exp(mx - m_all) for den, mx in zip(dens, mxs)]
    w_sum = w[0] + w[1] + w[2]
    y = (w[0][..., None] * outs[0] + w[1][..., None] * outs[1] + w[2][..., None] * outs[2]) / w_sum[..., None]
    b, s_len = q.shape[0], q.shape[1]
    return y.reshape(b, s_len, D_B).astype(q.dtype)


def setup_inputs(seed: int = 0) -> dict:
    key = jax.random.key(seed)
    ks = jax.random.split(key, 20)
    nrm = lambda k, shape, scale: jax.random.normal(k, shape, jnp.float32) * scale
    gain = lambda k, shape: 1.0 + 0.05 * jax.random.normal(k, shape, jnp.float32)
    return {
        "x": nrm(ks[0], (BATCH, SEQ, D_MODEL), 1.0),
        "p": nrm(ks[1], (DEPTH, BATCH, SEQ, D_PLE), 1.0),
        "w_in": nrm(ks[2], (DEPTH, D_MODEL, D_IN), D_MODEL ** -0.5),
        "g_attn_pre": gain(ks[3], (DEPTH, D_MODEL)),
        "g_q": gain(ks[4], (DEPTH, HEAD_DIM)),
        "g_k": gain(ks[5], (DEPTH, HEAD_DIM)),
        "g_out_a": gain(ks[6], (DEPTH, D_A)),
        "g_out_b": gain(ks[7], (DEPTH, D_B)),
        "w_out": nrm(ks[8], (DEPTH, D_MIX, D_MODEL), D_MIX ** -0.5),
        "g_attn_post": gain(ks[9], (DEPTH, D_MODEL)),
        "rel_bias": nrm(ks[10], (N_BUCKETS, N_HEADS_B), 0.5),
        "g_mlp_pre": gain(ks[11], (DEPTH, D_MODEL)),
        "w_ff1": nrm(ks[12], (DEPTH, D_MODEL, D_FF), D_MODEL ** -0.5),
        "w_ff2": nrm(ks[13], (DEPTH, D_FF, D_MODEL), D_FF ** -0.5),
        "g_mlp_post": gain(ks[14], (DEPTH, D_MODEL)),
        "g_ple": gain(ks[15], (DEPTH, D_MODEL)),
        "w_ple_gate": nrm(ks[16], (DEPTH, D_MODEL, D_MODEL), D_MODEL ** -0.5),
        "w_ple_proj": nrm(ks[17], (DEPTH, D_PLE, D_MODEL), D_PLE ** -0.5),
    }


def reference(x, p, w_in, g_attn_pre, g_q, g_k, g_out_a, g_out_b, w_out, g_attn_post, rel_bias,
              g_mlp_pre, w_ff1, w_ff2, g_mlp_post, g_ple, w_ple_gate, w_ple_proj):
    b, s_len = x.shape[0], x.shape[1]
    cos, sin = axial_rope_tables(s_len)
    split_at = [D_A, D_A + D_KV_A, D_A + 2 * D_KV_A, D_A + 2 * D_KV_A + D_B, D_A + 2 * D_KV_A + 2 * D_B]
    h = x
    for i in range(DEPTH):
        xn = rms_norm(h, g_attn_pre[i])
        proj = jnp.einsum('bsd,de->bse', xn, w_in[i])
        qa, ka, va, qb, kb, vb = jnp.split(proj, split_at, axis=-1)
        ya = mixer_a(qa.reshape(b, s_len, N_HEADS_A, HEAD_DIM),
                     ka.reshape(b, s_len, N_KV_A, HEAD_DIM),
                     va.reshape(b, s_len, N_KV_A, HEAD_DIM), g_q[i], g_k[i], cos, sin)
        yb = mixer_b(qb.reshape(b, s_len, N_HEADS_B, HEAD_DIM),
                     kb.reshape(b, s_len, N_HEADS_B, HEAD_DIM),
                     vb.reshape(b, s_len, N_HEADS_B, HEAD_DIM), rel_bias)
        y = jnp.concatenate([rms_norm(ya, g_out_a[i]), rms_norm(yb, g_out_b[i])], axis=-1)
        y = jnp.einsum('bse,ed->bsd', y, w_out[i])
        h = h + rms_norm(y, g_attn_post[i])
        xn = rms_norm(h, g_mlp_pre[i])
        f = jnp.square(jax.nn.relu(jnp.einsum('bsd,df->bsf', xn, w_ff1[i])))
        f = jnp.einsum('bsf,fd->bsd', f, w_ff2[i])
        h = h + rms_norm(f, g_mlp_post[i])
        gate = jax.nn.sigmoid(jnp.einsum('bsd,de->bse', rms_norm(h, g_ple[i]), w_ple_gate[i]))
        h = h + gate * jnp.einsum('bsp,pd->bsd', p[i], w_ple_proj[i])
    return h
```

```cpp
#include <hip/hip_runtime.h>
#include <cstdint>
#include <cstdio>

typedef unsigned short bf16;
typedef unsigned v4u __attribute__((ext_vector_type(4)));
typedef unsigned v2u __attribute__((ext_vector_type(2)));
typedef float f32x4 __attribute__((ext_vector_type(4)));
typedef float f32x2 __attribute__((ext_vector_type(2)));

namespace C {
constexpr int M = 16384, D = 1024, DIN = 2304, DFF = 4096, DPLE = 256, HD = 64;
constexpr int QA0 = 0, KA0 = 512, VA0 = 640, QB0 = 768, KB0 = 1280, VB0 = 1792;
constexpr float EPS = 1e-6f;
constexpr float LOG2E = 1.4426950408889634f;
constexpr float C2 = 0.125f * LOG2E;
constexpr size_t MiB = 1u << 20;
constexpr size_t WS_CTL = 0;
constexpr size_t WS_XCH = 1 * MiB;
constexpr size_t WS_WIN = 3 * MiB, WS_WOUT = 8 * MiB, WS_W1 = 10 * MiB, WS_W2 = 18 * MiB, WS_WG = 26 * MiB, WS_WP = 28 * MiB;
constexpr size_t WS_P16 = 29 * MiB;
constexpr size_t WS_XA = 40 * MiB, WS_XB = 72 * MiB;
constexpr size_t WS_OV = 104 * MiB;
constexpr size_t WS_PROJ = WS_OV;
constexpr size_t WS_YA = WS_OV + 72 * MiB;
constexpr size_t WS_PB = WS_OV + 88 * MiB;
constexpr size_t WS_PBS = WS_OV + 136 * MiB;
constexpr size_t WS_H = WS_OV;
constexpr size_t WS_PLE = WS_OV;
constexpr size_t WS_TMP = WS_OV + 32 * MiB;
constexpr size_t WS_END = WS_OV + 139 * MiB;
}
using namespace C;

__device__ __forceinline__ unsigned f2bf(float f) { unsigned u = __builtin_bit_cast(unsigned, f); return (u + 0x7fffu + ((u >> 16) & 1u)) >> 16; }
__device__ __forceinline__ unsigned pk2(float lo, float hi) { return f2bf(lo) | (f2bf(hi) << 16); }
__device__ __forceinline__ float bflo(unsigned w) { return __builtin_bit_cast(float, w << 16); }
__device__ __forceinline__ float bfhi(unsigned w) { return __builtin_bit_cast(float, w & 0xffff0000u); }
__device__ __forceinline__ float bf2f(bf16 b) { return __builtin_bit_cast(float, (unsigned)b << 16); }
__device__ __forceinline__ float wave_sum(float v) {
#pragma unroll
    for (int o = 1; o < 64; o <<= 1) v += __shfl_xor(v, o);
    return v;
}
__device__ __forceinline__ void unpack8(v4u w, float* f) {
    f[0] = bflo(w.x); f[1] = bfhi(w.x); f[2] = bflo(w.y); f[3] = bfhi(w.y); f[4] = bflo(w.z); f[5] = bfhi(w.z); f[6] = bflo(w.w); f[7] = bfhi(w.w);
}
__device__ __forceinline__ v4u pack8(const float* f) { v4u w; w.x = pk2(f[0], f[1]); w.y = pk2(f[2], f[3]); w.z = pk2(f[4], f[5]); w.w = pk2(f[6], f[7]); return w; }

__device__ __forceinline__ void p0_transpose_item(const float* W, int K, int N, bf16* WT, const float* g0, const float* g1, int split, float* scr, int item, int lane) {
    const int nblk = N / 32, kb = item / nblk, nb = item % nblk, k0 = 64 * kb, n0 = 32 * nb;
#pragma unroll 8
    for (int i = 0; i < 32; ++i) {
        const int kk = 2 * i + (lane >> 5), k = k0 + kk;
        float gv = 1.f; if (g0) gv = (k < split) ? g0[k] : g1[k - split];
        scr[kk * 33 + (lane & 31)] = W[(size_t)k * N + n0 + (lane & 31)] * gv;
    }
    asm volatile("s_waitcnt lgkmcnt(0)" ::: "memory");
    const int c = lane & 7;
#pragma unroll
    for (int j = 0; j < 4; ++j) {
        const int n = (lane >> 3) + 8 * j; const float* s = scr + (8 * c) * 33 + n;
        v4u o; o.x = pk2(s[0 * 33], s[1 * 33]); o.y = pk2(s[2 * 33], s[3 * 33]); o.z = pk2(s[4 * 33], s[5 * 33]); o.w = pk2(s[6 * 33], s[7 * 33]);
        *(v4u*)(WT + (size_t)(n0 + n) * K + k0 + 8 * c) = o;
    }
    asm volatile("s_waitcnt lgkmcnt(0)" ::: "memory");
}
__device__ __forceinline__ void rms_row_to_bf16(const float* xrow, bf16* orow, int lane) {
    const f32x4* xr = (const f32x4*)xrow + lane;
    f32x4 v[4]; float s = 0.f;
#pragma unroll
    for (int j = 0; j < 4; ++j) { v[j] = xr[64 * j]; s += (v[j].x * v[j].x + v[j].y * v[j].y) + (v[j].z * v[j].z + v[j].w * v[j].w); }
    const float rstd = 1.f / sqrtf(wave_sum(s) * (1.f / D) + EPS);
    v2u* o8 = (v2u*)orow + lane;
#pragma unroll
    for (int j = 0; j < 4; ++j) { v2u w; w.x = pk2(v[j].x * rstd, v[j].y * rstd); w.y = pk2(v[j].z * rstd, v[j].w * rstd); o8[64 * j] = w; }
}
struct P0Args { const float *x, *p, *w_in, *g_attn_pre, *g_out_a, *g_out_b, *w_out, *g_mlp_pre, *w_ff1, *w_ff2, *g_ple, *w_gate, *w_ple; unsigned char* ws; };
__device__ __forceinline__ void p0_run(const P0Args& a, float* scr, int gw, int ngw, int lane) {
    bf16* Win = (bf16*)(a.ws + WS_WIN); bf16* Wout = (bf16*)(a.ws + WS_WOUT); bf16* W1 = (bf16*)(a.ws + WS_W1); bf16* W2 = (bf16*)(a.ws + WS_W2);
    bf16* Wg = (bf16*)(a.ws + WS_WG); bf16* Wp = (bf16*)(a.ws + WS_WP);
    constexpr int I_IN = (D / 64) * (DIN / 32), I_OUT = (D / 64) * (D / 32), I_1 = (D / 64) * (DFF / 32), I_2 = (DFF / 64) * (D / 32), I_G = I_OUT, I_P = (DPLE / 64) * (D / 32);
    constexpr int NITEMS = I_IN + I_OUT + I_1 + I_2 + I_G + I_P;
    for (int it = gw; it < NITEMS; it += ngw) {
        int r = it;
        if (r < I_IN) { p0_transpose_item(a.w_in, D, DIN, Win, a.g_attn_pre, a.g_attn_pre, D, scr, r, lane); continue; } r -= I_IN;
        if (r < I_OUT) { p0_transpose_item(a.w_out, D, D, Wout, a.g_out_a, a.g_out_b, 512, scr, r, lane); continue; } r -= I_OUT;
        if (r < I_1) { p0_transpose_item(a.w_ff1, D, DFF, W1, a.g_mlp_pre, a.g_mlp_pre, D, scr, r, lane); continue; } r -= I_1;
        if (r < I_2) { p0_transpose_item(a.w_ff2, DFF, D, W2, nullptr, nullptr, 0, scr, r, lane); continue; } r -= I_2;
        if (r < I_G) { p0_transpose_item(a.w_gate, D, D, Wg, a.g_ple, a.g_ple, D, scr, r, lane); continue; } r -= I_G;
        p0_transpose_item(a.w_ple, DPLE, D, Wp, nullptr, nullptr, 0, scr, r, lane);
    }
    bf16* XA = (bf16*)(a.ws + WS_XA); bf16* P16 = (bf16*)(a.ws + WS_P16);
    for (int m = gw; m < M; m += ngw) {
        rms_row_to_bf16(a.x + (size_t)m * D, XA + (size_t)m * D, lane);
        const f32x4 v = ((const f32x4*)(a.p + (size_t)m * DPLE))[lane];
        v2u w; w.x = pk2(v.x, v.y); w.y = pk2(v.z, v.w); ((v2u*)(P16 + (size_t)m * DPLE))[lane] = w;
    }
}
__global__ void __launch_bounds__(256) k_p0(P0Args a) {
    __shared__ float scr[4][64 * 33];
    const int lane = threadIdx.x & 63, w = threadIdx.x >> 6;
    p0_run(a, scr[w], blockIdx.x * 4 + w, gridDim.x * 4, lane);
}

__device__ __forceinline__ void fix_qk_token(bf16* prow, int t, const float* g_q, const float* g_k, int lane) {
    const int c = lane & 7, cc = c & 3;
    const int prow_ = t >> 6, pcol = t & 63;
    const float pos = (cc < 2) ? (float)prow_ : (float)pcol;
    float cs[8], sn[8];
#pragma unroll
    for (int e = 0; e < 8; ++e) {
        const int fi = (8 * cc + e) & 15;
        const float invf = __builtin_amdgcn_exp2f(-(float)fi * (13.287712379549449f / 16.f));
        float rev = pos * invf * 0.15915494309189535f; rev = rev - floorf(rev);
        cs[e] = __builtin_amdgcn_cosf(rev); sn[e] = __builtin_amdgcn_sinf(rev);
    }
#pragma unroll
    for (int pass = 0; pass < 2; ++pass) {
        const bool isq = (pass == 0);
        if (!isq && lane >= 16) break;
        bf16* base = prow + (isq ? QA0 : KA0) + lane * 8;
        const float* g = isq ? g_q : g_k;
        float f[8]; unpack8(*(const v4u*)base, f);
        float s = 0.f;
#pragma unroll
        for (int e = 0; e < 8; ++e) s += f[e] * f[e];
        s += __shfl_xor(s, 1); s += __shfl_xor(s, 2); s += __shfl_xor(s, 4);
        const float rstd = 1.f / sqrtf(s * (1.f / 64.f) + EPS);
        float o[8];
#pragma unroll
        for (int e = 0; e < 8; ++e) { f[e] = f[e] * rstd * g[8 * c + e]; }
#pragma unroll
        for (int e = 0; e < 8; ++e) {
            const float other = __shfl_xor(f[e], 4);
            o[e] = (c < 4) ? (f[e] * cs[e] - other * sn[e]) : (f[e] * cs[e] + other * sn[e]);
            if (isq) o[e] *= C2;
        }
        *(v4u*)base = pack8(o);
    }
}
__global__ void __launch_bounds__(256) k_fixqk(bf16* PROJ, const float* g_q, const float* g_k) {
    const int lane = threadIdx.x & 63, gw = blockIdx.x * 4 + (threadIdx.x >> 6), ngw = gridDim.x * 4;
    for (int t = gw; t < M; t += ngw) fix_qk_token(PROJ + (size_t)t * DIN, t, g_q, g_k, lane);
}

template <int MODE> __global__ void __launch_bounds__(256) k_gemm(const bf16* A, int lda, const bf16* Bt, int K, void* Cv, int ldc) {
    __shared__ float As[32][68], Bs[32][68];
    const int t = threadIdx.x, tx = t & 15, ty = t >> 4;
    const int m0 = blockIdx.y * 64, n0 = blockIdx.x * 64;
    float acc[4][4];
#pragma unroll
    for (int i = 0; i < 4; ++i)
#pragma unroll
        for (int j = 0; j < 4; ++j) acc[i][j] = 0.f;
    const int lr = t >> 2, lk = (t & 3) * 8;
    for (int k0 = 0; k0 < K; k0 += 32) {
        float fa[8], fb[8];
        unpack8(*(const v4u*)(A + (size_t)(m0 + lr) * lda + k0 + lk), fa);
        unpack8(*(const v4u*)(Bt + (size_t)(n0 + lr) * K + k0 + lk), fb);
#pragma unroll
        for (int e = 0; e < 8; ++e) { As[lk + e][lr] = fa[e]; Bs[lk + e][lr] = fb[e]; }
        __syncthreads();
#pragma unroll 8
        for (int kk = 0; kk < 32; ++kk) {
            const f32x4 a = *(const f32x4*)&As[kk][ty * 4], b = *(const f32x4*)&Bs[kk][tx * 4];
#pragma unroll
            for (int i = 0; i < 4; ++i)
#pragma unroll
                for (int j = 0; j < 4; ++j) acc[i][j] += a[i] * b[j];
        }
        __syncthreads();
    }
#pragma unroll
    for (int i = 0; i < 4; ++i) {
        const int m = m0 + ty * 4 + i, n = n0 + tx * 4;
        float v[4];
#pragma unroll
        for (int j = 0; j < 4; ++j) v[j] = acc[i][j];
        if (MODE == 0) { const float sc = (n >= QB0 && n < KB0) ? C2 : 1.f;
#pragma unroll
            for (int j = 0; j < 4; ++j) v[j] *= sc; }
        if (MODE == 2) {
#pragma unroll
            for (int j = 0; j < 4; ++j) { const float r = v[j] > 0.f ? v[j] : 0.f; v[j] = r * r; } }
        if (MODE == 1) { *(f32x4*)((float*)Cv + (size_t)m * ldc + n) = (f32x4){v[0], v[1], v[2], v[3]}; }
        else { v2u w; w.x = pk2(v[0], v[1]); w.y = pk2(v[2], v[3]); *(v2u*)((bf16*)Cv + (size_t)m * ldc + n) = w; }
    }
}

__global__ void __launch_bounds__(256) k_attn_a(const bf16* PROJ, bf16* YA) {
    __shared__ float Ks[64][64], Vs[64][64];
    const int t = threadIdx.x, h = blockIdx.y, kvh = h >> 2, q = blockIdx.x * 256 + t;
    float qv[64], o[64];
#pragma unroll
    for (int c = 0; c < 8; ++c) unpack8(*(const v4u*)(PROJ + (size_t)q * DIN + QA0 + h * 64 + c * 8), qv + 8 * c);
#pragma unroll
    for (int d = 0; d < 64; ++d) o[d] = 0.f;
    float mx = -1e30f, l = 0.f;
    for (int k0 = 0; k0 < M; k0 += 64) {
        __syncthreads();
        {
#pragma unroll
            for (int i = 0; i < 2; ++i) {
                const int idx = t + 256 * i, r = idx >> 3, c = idx & 7; float f[8];
                unpack8(*(const v4u*)(PROJ + (size_t)(k0 + r) * DIN + KA0 + kvh * 64 + c * 8), f);
#pragma unroll
                for (int e = 0; e < 8; ++e) Ks[r][c * 8 + e] = f[e];
                unpack8(*(const v4u*)(PROJ + (size_t)(k0 + r) * DIN + VA0 + kvh * 64 + c * 8), f);
#pragma unroll
                for (int e = 0; e < 8; ++e) Vs[r][c * 8 + e] = f[e];
            }
        }
        __syncthreads();
        for (int j = 0; j < 64; ++j) {
            float s = 0.f;
#pragma unroll
            for (int d = 0; d < 64; d += 4) { const f32x4 kk = *(const f32x4*)&Ks[j][d]; s += qv[d] * kk.x + qv[d + 1] * kk.y + qv[d + 2] * kk.z + qv[d + 3] * kk.w; }
            const float mn = fmaxf(mx, s), al = __builtin_amdgcn_exp2f(mx - mn), p = __builtin_amdgcn_exp2f(s - mn);
            mx = mn; l = l * al + p;
#pragma unroll
            for (int d = 0; d < 64; d += 4) { const f32x4 vv = *(const f32x4*)&Vs[j][d]; o[d] = o[d] * al + p * vv.x; o[d + 1] = o[d + 1] * al + p * vv.y; o[d + 2] = o[d + 2] * al + p * vv.z; o[d + 3] = o[d + 3] * al + p * vv.w; }
        }
    }
    const float il = 1.f / l;
#pragma unroll
    for (int c = 0; c < 8; ++c) { float f[8];
#pragma unroll
        for (int e = 0; e < 8; ++e) f[e] = o[8 * c + e] * il;
        *(v4u*)(YA + (size_t)q * 512 + h * 64 + c * 8) = pack8(f); }
}

__device__ __forceinline__ int t5_bucket(int rel) {
    const int side = rel > 0 ? 16 : 0, n = rel < 0 ? -rel : rel;
    const int large = 8 + (n >= 15) + (n >= 27) + (n >= 50) + (n >= 91) + (n >= 166) + (n >= 305) + (n >= 559);
    return side + (n < 8 ? n : large);
}
__global__ void __launch_bounds__(256) k_mix_b(const bf16* PROJ, const float* rel_bias, bf16* PB, f32x2* PBS) {
    const int idx = blockIdx.x * 256 + threadIdx.x;
    const int pat = idx / (M * 8), h = (idx / M) & 7, t = idx % M;
    const int dil = pat == 0 ? 1 : (pat == 1 ? 4 : 16), L = M / dil, m = t / dil, r = t % dil;
    float qv[64], o[64];
#pragma unroll
    for (int c = 0; c < 8; ++c) unpack8(*(const v4u*)(PROJ + (size_t)t * DIN + QB0 + h * 64 + c * 8), qv + 8 * c);
#pragma unroll
    for (int d = 0; d < 64; ++d) o[d] = 0.f;
    float mx = -1e30f, l = 0.f;
    for (int j = -64; j <= 64; ++j) {
        const int mk = m + j; if (mk < 0 || mk >= L) continue;
        const int tk = mk * dil + r;
        float s = rel_bias[t5_bucket(j * dil) * 8 + h] * LOG2E;
#pragma unroll
        for (int c = 0; c < 8; ++c) { float f[8]; unpack8(*(const v4u*)(PROJ + (size_t)tk * DIN + KB0 + h * 64 + c * 8), f);
#pragma unroll
            for (int e = 0; e < 8; ++e) s += qv[8 * c + e] * f[e]; }
        const float mn = fmaxf(mx, s), al = __builtin_amdgcn_exp2f(mx - mn), p = __builtin_amdgcn_exp2f(s - mn);
        mx = mn; l = l * al + p;
#pragma unroll
        for (int c = 0; c < 8; ++c) { float f[8]; unpack8(*(const v4u*)(PROJ + (size_t)tk * DIN + VB0 + h * 64 + c * 8), f);
#pragma unroll
            for (int e = 0; e < 8; ++e) o[8 * c + e] = o[8 * c + e] * al + p * f[e]; }
    }
    bf16* dst = PB + ((size_t)pat * M + t) * 512 + h * 64;
#pragma unroll
    for (int c = 0; c < 8; ++c) *(v4u*)(dst + c * 8) = pack8(o + 8 * c);
    PBS[((size_t)pat * M + t) * 8 + h] = (f32x2){mx, l};
}

__device__ __forceinline__ void p3a_token(const bf16* YA, const bf16* PB, const f32x2* PBS, bf16* Y, int t, int lane) {
    {
        float f[8]; unpack8(*(const v4u*)(YA + (size_t)t * 512 + lane * 8), f);
        float s = 0.f;
#pragma unroll
        for (int e = 0; e < 8; ++e) s += f[e] * f[e];
        const float rstd = 1.f / sqrtf(wave_sum(s) * (1.f / 512.f) + EPS);
#pragma unroll
        for (int e = 0; e < 8; ++e) f[e] *= rstd;
        *(v4u*)(Y + (size_t)t * D + lane * 8) = pack8(f);
    }
    {
        const int h = lane >> 3;
        f32x2 st[3]; float a[3][8];
#pragma unroll
        for (int p = 0; p < 3; ++p) { st[p] = PBS[((size_t)p * M + t) * 8 + h]; unpack8(*(const v4u*)(PB + ((size_t)p * M + t) * 512 + lane * 8), a[p]); }
        const float mm = fmaxf(fmaxf(st[0].x, st[1].x), st[2].x);
        const float w0 = __builtin_amdgcn_exp2f(st[0].x - mm), w1 = __builtin_amdgcn_exp2f(st[1].x - mm), w2 = __builtin_amdgcn_exp2f(st[2].x - mm);
        const float den = st[0].y * w0 + st[1].y * w1 + st[2].y * w2, iden = 1.f / den;
        float f[8]; float s = 0.f;
#pragma unroll
        for (int e = 0; e < 8; ++e) { f[e] = (a[0][e] * w0 + a[1][e] * w1 + a[2][e] * w2) * iden; s += f[e] * f[e]; }
        const float rstd = 1.f / sqrtf(wave_sum(s) * (1.f / 512.f) + EPS);
#pragma unroll
        for (int e = 0; e < 8; ++e) f[e] *= rstd;
        *(v4u*)(Y + (size_t)t * D + 512 + lane * 8) = pack8(f);
    }
}
__global__ void __launch_bounds__(256) k_p3a(const bf16* YA, const bf16* PB, const f32x2* PBS, bf16* Y) {
    const int lane = threadIdx.x & 63, gw = blockIdx.x * 4 + (threadIdx.x >> 6), ngw = gridDim.x * 4;
    for (int t = gw; t < M; t += ngw) p3a_token(YA, PB, PBS, Y, t, lane);
}

__global__ void __launch_bounds__(256) k_row_res_norm(const float* tmp, const float* base, const float* g, float* out, bf16* xn, int nrows) {
    const int lane = threadIdx.x & 63, gw = blockIdx.x * 4 + (threadIdx.x >> 6), ngw = gridDim.x * 4;
    for (int m = gw; m < nrows; m += ngw) {
        const f32x4* tr = (const f32x4*)(tmp + (size_t)m * D) + lane; const f32x4* br = (const f32x4*)(base + (size_t)m * D) + lane; const f32x4* gr = (const f32x4*)g + lane;
        f32x4 v[4]; float s = 0.f;
#pragma unroll
        for (int j = 0; j < 4; ++j) { v[j] = tr[64 * j]; s += (v[j].x * v[j].x + v[j].y * v[j].y) + (v[j].z * v[j].z + v[j].w * v[j].w); }
        const float rstd = 1.f / sqrtf(wave_sum(s) * (1.f / D) + EPS);
        float s2 = 0.f;
#pragma unroll
        for (int j = 0; j < 4; ++j) { v[j] = br[64 * j] + v[j] * rstd * gr[64 * j]; s2 += (v[j].x * v[j].x + v[j].y * v[j].y) + (v[j].z * v[j].z + v[j].w * v[j].w); }
        const float rstd2 = 1.f / sqrtf(wave_sum(s2) * (1.f / D) + EPS);
        f32x4* orow = (f32x4*)(out + (size_t)m * D) + lane; v2u* xr = (v2u*)(xn + (size_t)m * D) + lane;
#pragma unroll
        for (int j = 0; j < 4; ++j) { orow[64 * j] = v[j]; v2u w; w.x = pk2(v[j].x * rstd2, v[j].y * rstd2); w.y = pk2(v[j].z * rstd2, v[j].w * rstd2); xr[64 * j] = w; }
    }
}
__global__ void __launch_bounds__(256) k_row_final(const float* gate, const bf16* ple, float* out) {
    const int lane = threadIdx.x & 63, gw = blockIdx.x * 4 + (threadIdx.x >> 6), ngw = gridDim.x * 4;
    for (int m = gw; m < M; m += ngw) {
        const f32x4* gr = (const f32x4*)(gate + (size_t)m * D) + lane; const v2u* pr = (const v2u*)(ple + (size_t)m * D) + lane; f32x4* orow = (f32x4*)(out + (size_t)m * D) + lane;
#pragma unroll
        for (int j = 0; j < 4; ++j) {
            const f32x4 gv = gr[64 * j]; const v2u pw = pr[64 * j]; f32x4 o = orow[64 * j];
            o.x += bflo(pw.x) / (1.f + __expf(-gv.x)); o.y += bfhi(pw.x) / (1.f + __expf(-gv.y)); o.z += bflo(pw.y) / (1.f + __expf(-gv.z)); o.w += bfhi(pw.y) / (1.f + __expf(-gv.w));
            orow[64 * j] = o;
        }
    }
}

extern "C" void kernel_launch(void* const* d_in, const int* in_sizes, int n_in, void* d_out, int out_size, void* d_ws, size_t ws_size, hipStream_t stream) {
    if (n_in != 18 || out_size != M * D || ws_size < WS_END) { fprintf(stderr, "kernel_launch: unexpected problem shape (n_in %d out %d ws %zu)\n", n_in, out_size, ws_size); return; }
    const float* x = (const float*)d_in[0]; const float* p = (const float*)d_in[1]; const float* w_in = (const float*)d_in[2]; const float* g_attn_pre = (const float*)d_in[3];
    const float* g_q = (const float*)d_in[4]; const float* g_k = (const float*)d_in[5]; const float* g_out_a = (const float*)d_in[6]; const float* g_out_b = (const float*)d_in[7];
    const float* w_out = (const float*)d_in[8]; const float* g_attn_post = (const float*)d_in[9]; const float* rel_bias = (const float*)d_in[10]; const float* g_mlp_pre = (const float*)d_in[11];
    const float* w_ff1 = (const float*)d_in[12]; const float* w_ff2 = (const float*)d_in[13]; const float* g_mlp_post = (const float*)d_in[14]; const float* g_ple = (const float*)d_in[15];
    const float* w_gate = (const float*)d_in[16]; const float* w_ple = (const float*)d_in[17];
    unsigned char* ws = (unsigned char*)d_ws; float* out = (float*)d_out;
    bf16* Win = (bf16*)(ws + WS_WIN); bf16* Wout = (bf16*)(ws + WS_WOUT); bf16* W1 = (bf16*)(ws + WS_W1); bf16* W2 = (bf16*)(ws + WS_W2); bf16* Wg = (bf16*)(ws + WS_WG); bf16* Wp = (bf16*)(ws + WS_WP);
    bf16* P16 = (bf16*)(ws + WS_P16); bf16* XA = (bf16*)(ws + WS_XA); bf16* XB = (bf16*)(ws + WS_XB); bf16* PROJ = (bf16*)(ws + WS_PROJ); bf16* YA = (bf16*)(ws + WS_YA);
    bf16* PB = (bf16*)(ws + WS_PB); f32x2* PBS = (f32x2*)(ws + WS_PBS); bf16* H = (bf16*)(ws + WS_H); bf16* PLE = (bf16*)(ws + WS_PLE); float* TMP = (float*)(ws + WS_TMP);

    P0Args a0{x, p, w_in, g_attn_pre, g_out_a, g_out_b, w_out, g_mlp_pre, w_ff1, w_ff2, g_ple, w_gate, w_ple, ws};
    k_p0<<<1024, 256, 0, stream>>>(a0);
    k_gemm<0><<<dim3(DIN / 64, M / 64), 256, 0, stream>>>(XA, D, Win, D, PROJ, DIN);
    k_fixqk<<<1024, 256, 0, stream>>>(PROJ, g_q, g_k);
    k_attn_a<<<dim3(M / 256, 8), 256, 0, stream>>>(PROJ, YA);
    k_mix_b<<<(3 * 8 * M) / 256, 256, 0, stream>>>(PROJ, rel_bias, PB, PBS);
    k_p3a<<<1024, 256, 0, stream>>>(YA, PB, PBS, XA);
    k_gemm<1><<<dim3(D / 64, M / 64), 256, 0, stream>>>(XA, D, Wout, D, TMP, D);
    k_row_res_norm<<<1024, 256, 0, stream>>>(TMP, x, g_attn_post, out, XB, M);
    k_gemm<2><<<dim3(DFF / 64, M / 64), 256, 0, stream>>>(XB, D, W1, D, H, DFF);
    for (int hf = 0; hf < 2; ++hf) {
        const size_t r0 = (size_t)hf * 8192;
        k_gemm<1><<<dim3(D / 64, 8192 / 64), 256, 0, stream>>>(H + r0 * DFF, DFF, W2, DFF, (float*)XB, D);
        k_row_res_norm<<<1024, 256, 0, stream>>>((const float*)XB, out + r0 * D, g_mlp_post, out + r0 * D, XA + r0 * D, 8192);
    }
    k_gemm<3><<<dim3(D / 64, M / 64), 256, 0, stream>>>(P16, DPLE, Wp, DPLE, PLE, D);
    k_gemm<1><<<dim3(D / 64, M / 64), 256, 0, stream>>>(XA, D, Wg, D, TMP, D);
    k_row_final<<<1024, 256, 0, stream>>>(TMP, PLE, out);
}
```
